# Optimizing an MI355X kernel written in HIP

```python
import math
import jax, jax.numpy as jnp
from jax import lax
import numpy as np

D_MODEL = 2048
BATCH = 4
SEQ = 2048
DEPTH = 4

D_MIX = D_MODEL
A_WIDTH = D_MIX // 2
A_HEADS = 8
A_HEAD_DIM = A_WIDTH // A_HEADS
IDX_HEADS = 16
IDX_DIM = 64
TOPK_MAX = 256
Q_BLOCK = 64
B_WIDTH = D_MIX - A_WIDTH
B_HEADS = 4
B_KEY_WIDTH = B_WIDTH // 2
B_DK = B_KEY_WIDTH // B_HEADS
B_DV = B_WIDTH // B_HEADS
GATE_RANK = 16
GATE_TEMP = 16.0
CHUNK = 64
NUM_BUCKETS = 32
MAX_DISTANCE = 128
EPS = 1e-6

IN_WIDTHS = (A_WIDTH, A_WIDTH, A_WIDTH, A_WIDTH,
             IDX_HEADS * IDX_DIM, IDX_DIM, IDX_HEADS,
             B_KEY_WIDTH, B_KEY_WIDTH, B_WIDTH, B_WIDTH,
             GATE_RANK)
IN_COLS = sum(IN_WIDTHS)

kernel_name = "hymba_dsa_gla_adaln_trunk"


def rmsnorm(x, g):
    x32 = x.astype(jnp.float32)
    r = x32 * lax.rsqrt(jnp.mean(x32 * x32, axis=-1, keepdims=True) + EPS)
    return (r * g.astype(jnp.float32)).astype(x.dtype)


def t5_bucket(dist):
    max_exact = NUM_BUCKETS // 2
    d = jnp.maximum(dist, 0)
    df = jnp.maximum(d, 1).astype(jnp.float32)
    large = max_exact + (jnp.log(df / max_exact) / math.log(MAX_DISTANCE / max_exact)
                         * (NUM_BUCKETS - max_exact)).astype(jnp.int32)
    large = jnp.minimum(large, NUM_BUCKETS - 1)
    return jnp.where(d < max_exact, d, large)


def dsa_attention(q, k, v, iq, ik, iw, rel_bias):
    bsz, T, H, dh = q.shape
    topk = min(TOPK_MAX, T // 4)
    nb = T // Q_BLOCK

    def blockify(a):
        return jnp.moveaxis(a.reshape((bsz, nb, Q_BLOCK) + a.shape[2:]), 1, 0)

    key_pos = jnp.arange(T, dtype=jnp.int32)
    ik32 = ik.astype(jnp.float32)
    iw32 = iw.astype(jnp.float32) * (IDX_HEADS ** -0.5 * IDX_DIM ** -0.5)
    gather = jax.vmap(lambda kb, ib: kb[ib])

    def one_block(args):
        qb, iqb, iwb, start = args
        qpos = start + jnp.arange(Q_BLOCK, dtype=jnp.int32)
        s = jnp.einsum('bqjd,bsd->bqsj', iqb.astype(jnp.float32), ik32)
        score = jnp.einsum('bqsj,bqj->bqs', jax.nn.relu(s), iwb)
        causal = key_pos[None, :] <= qpos[:, None]
        score = jnp.where(causal[None], score, -jnp.inf)
        _, idx = lax.top_k(score, topk)
        valid = idx <= qpos[None, :, None]
        ks = gather(k, idx)
        vs = gather(v, idx)
        logits = jnp.einsum('bqhd,bqkhd->bhqk', qb, ks,
                            preferred_element_type=jnp.float32) * (dh ** -0.5)
        bucket = t5_bucket(qpos[None, :, None] - idx)
        logits = logits + jnp.moveaxis(rel_bias.astype(jnp.float32)[bucket], -1, 1)
        logits = jnp.where(valid[:, None], logits, -jnp.inf)
        p = jax.nn.softmax(logits, axis=-1)
        return jnp.einsum('bhqk,bqkhd->bqhd', p.astype(v.dtype), vs)

    starts = jnp.arange(nb, dtype=jnp.int32) * Q_BLOCK
    out = lax.map(one_block, (blockify(q), blockify(iq), blockify(iw32), starts))
    return jnp.moveaxis(out, 0, 1).reshape(bsz, T, H, dh)


def gla_chunked(q, k, v, log_a):
    bsz, T, H, dk = q.shape
    dv = v.shape[-1]
    nc = T // CHUNK
    f32 = jnp.float32

    def chunks(a):
        return jnp.moveaxis(a.astype(f32).reshape((bsz, nc, CHUNK) + a.shape[2:]), 1, 0)

    tri = jnp.tril(jnp.ones((CHUNK, CHUNK), dtype=bool))[None, :, :, None, None]

    def step(S, inp):
        qc, kc, vc, gc = inp
        b = jnp.cumsum(gc, axis=1)
        b_last = b[:, -1]
        o_inter = jnp.einsum('bthk,bhkv->bthv', qc * jnp.exp(b), S)
        diff = b[:, :, None] - b[:, None, :]
        decay = jnp.exp(jnp.where(tri, diff, -jnp.inf))
        attn = jnp.einsum('bthk,bshk,btshk->bhts', qc, kc, decay)
        o_intra = jnp.einsum('bhts,bshv->bthv', attn, vc)
        k_dec = kc * jnp.exp(b_last[:, None] - b)
        S_new = jnp.exp(b_last)[..., None] * S + jnp.einsum('bshk,bshv->bhkv', k_dec, vc)
        return S_new, o_inter + o_intra

    S0 = jnp.zeros((bsz, H, dk, dv), f32)
    _, o = lax.scan(step, S0, (chunks(q), chunks(k), chunks(v), chunks(log_a)))
    return jnp.moveaxis(o, 0, 1).reshape(bsz, T, H, dv).astype(v.dtype)


def hybrid_layer(x, shift, scale, gate, norm_g, w_in, w_alpha_up, b_alpha, gla_g,
                 w_out, rel_bias):
    bsz, T, _ = x.shape
    h = rmsnorm(x, norm_g) * (1.0 + scale[:, None]) + shift[:, None]
    proj = jnp.einsum('btd,dc->btc', h, w_in)
    points = np.cumsum(IN_WIDTHS)[:-1].tolist()
    aq, ak, av, ag, iq, ik, iw, bq, bk, bv, bg, ba = jnp.split(proj, points, axis=-1)

    heads_a = lambda a: a.reshape(bsz, T, A_HEADS, A_HEAD_DIM)
    a_out = dsa_attention(heads_a(aq), heads_a(ak), heads_a(av),
                          iq.reshape(bsz, T, IDX_HEADS, IDX_DIM), ik, iw, rel_bias)
    a_out = a_out.reshape(bsz, T, A_WIDTH) * jax.nn.silu(ag)

    pre = jnp.einsum('btr,rk->btk', ba, w_alpha_up) + b_alpha
    log_a = jax.nn.log_sigmoid(pre.astype(jnp.float32)) / GATE_TEMP
    heads_k = lambda a: a.reshape(bsz, T, B_HEADS, B_DK)
    b_out = gla_chunked(heads_k(bq) * (B_DK ** -0.5), heads_k(bk),
                        bv.reshape(bsz, T, B_HEADS, B_DV), heads_k(log_a))
    b_out = rmsnorm(b_out, gla_g).reshape(bsz, T, B_WIDTH) * jax.nn.silu(bg)

    y = jnp.einsum('btc,cd->btd', jnp.concatenate([a_out, b_out], axis=-1), w_out)
    return x + gate[:, None] * y


def setup_inputs(seed: int = 0) -> dict:
    key = jax.random.key(seed)
    ks = jax.random.split(key, 12)
    f32 = jnp.float32
    nrm = lambda k, shape, s: jax.random.normal(k, shape, f32) * s
    return {
        "x": nrm(ks[0], (BATCH, SEQ, D_MODEL), 1.0),
        "c": nrm(ks[1], (BATCH, D_MODEL), 1.0),
        "w_ada": nrm(ks[2], (DEPTH, D_MODEL, 3 * D_MODEL), 0.5 * D_MODEL ** -0.5),
        "b_ada": nrm(ks[3], (DEPTH, 3 * D_MODEL), 0.02),
        "norm_g": 1.0 + nrm(ks[4], (DEPTH, D_MODEL), 0.02),
        "w_in": nrm(ks[5], (DEPTH, D_MODEL, IN_COLS), D_MODEL ** -0.5),
        "w_alpha_up": nrm(ks[6], (DEPTH, GATE_RANK, B_KEY_WIDTH), GATE_RANK ** -0.5),
        "b_alpha": nrm(ks[7], (DEPTH, B_KEY_WIDTH), 0.02),
        "gla_g": 1.0 + nrm(ks[8], (DEPTH, B_DV), 0.02),
        "w_out": nrm(ks[9], (DEPTH, D_MIX, D_MODEL), D_MIX ** -0.5),
        "rel_bias": nrm(ks[10], (NUM_BUCKETS, A_HEADS), 0.5),
        "final_g": 1.0 + nrm(ks[11], (D_MODEL,), 0.02),
    }


def reference(x, c, w_ada, b_ada, norm_g, w_in, w_alpha_up, b_alpha, gla_g, w_out,
              rel_bias, final_g):
    c_act = jax.nn.silu(c)
    for l in range(DEPTH):
        mod = jnp.einsum('bd,de->be', c_act, w_ada[l]) + b_ada[l]
        shift, scale, gate = jnp.split(mod, 3, axis=-1)
        x = hybrid_layer(x, shift, scale, gate, norm_g[l], w_in[l], w_alpha_up[l],
                         b_alpha[l], gla_g[l], w_out[l], rel_bias)
    return rmsnorm(x, final_g)
```

```cpp
#include <hip/hip_runtime.h>
#include <cstdio>
#include <cstdint>

namespace nv {
constexpr int NB = 4, T = 2048, D = 2048, NL = 4, M = NB * T;
constexpr int NCOL = 8288;
constexpr float EPS = 1e-6f;
typedef _Float16 h16;

constexpr size_t MiB = 1u << 20;
constexpr size_t WS_MOD = 0;
constexpr size_t WS_CACT = 1 * MiB;
constexpr size_t WS_H = 2 * MiB;
constexpr size_t WS_XR = WS_H + 64 * MiB;
constexpr size_t WS_AQ = WS_XR + 64 * MiB;
constexpr size_t WS_AK = WS_AQ + 16 * MiB;
constexpr size_t WS_AV = WS_AK + 16 * MiB;
constexpr size_t WS_AG = WS_AV + 16 * MiB;
constexpr size_t WS_IQ = WS_AG + 16 * MiB;
constexpr size_t WS_BQ = WS_IQ + 16 * MiB;
constexpr size_t WS_BK = WS_BQ + 8 * MiB;
constexpr size_t WS_BV = WS_BK + 8 * MiB;
constexpr size_t WS_BG = WS_BV + 16 * MiB;
constexpr size_t WS_IK = WS_BG + 16 * MiB;
constexpr size_t WS_IW = WS_IK + 1 * MiB;
constexpr size_t WS_BA = WS_IW + 1 * MiB;
constexpr size_t WS_MASK = WS_BA + 1 * MiB;
constexpr size_t WS_CAT = WS_MASK + 2 * MiB;
constexpr size_t WS_BO = WS_CAT + 32 * MiB;
constexpr size_t WS_END = WS_BO + 32 * MiB;

struct P {
    const float *x, *c, *w_ada, *b_ada, *norm_g, *w_in, *w_up, *b_alpha, *gla_g, *w_out, *rel_bias, *final_g;
    float* out; unsigned char* ws;
};

__device__ __forceinline__ float silu(float x) { return x / (1.f + __expf(-x)); }

__global__ void k_cact(P p) {
    int i = blockIdx.x * 256 + threadIdx.x;
    if (i < NB * D) ((float*)(p.ws + WS_CACT))[i] = silu(p.c[i]);
}
__global__ void k_mod(P p) {
    int idx = blockIdx.x * 256 + threadIdx.x;
    int l = idx / 6144, e = idx % 6144;
    const float* ca = (const float*)(p.ws + WS_CACT);
    const float* w = p.w_ada + (size_t)l * D * 6144 + e;
    float a0 = 0, a1 = 0, a2 = 0, a3 = 0;
    for (int d = 0; d < D; ++d) {
        float wv = w[(size_t)d * 6144];
        a0 += ca[d] * wv; a1 += ca[D + d] * wv; a2 += ca[2 * D + d] * wv; a3 += ca[3 * D + d] * wv;
    }
    float bb = p.b_ada[l * 6144 + e];
    float* mod = (float*)(p.ws + WS_MOD) + (size_t)l * NB * 6144;
    mod[0 * 6144 + e] = a0 + bb; mod[1 * 6144 + e] = a1 + bb; mod[2 * 6144 + e] = a2 + bb; mod[3 * 6144 + e] = a3 + bb;
}

__device__ __forceinline__ float block_sum256(float v, float* red) {
    for (int o = 32; o > 0; o >>= 1) v += __shfl_xor(v, o);
    __syncthreads();
    if ((threadIdx.x & 63) == 0) red[threadIdx.x >> 6] = v;
    __syncthreads();
    return red[0] + red[1] + red[2] + red[3];
}
__device__ __forceinline__ float block_max256(float v, float* red) {
    for (int o = 32; o > 0; o >>= 1) v = fmaxf(v, __shfl_xor(v, o));
    __syncthreads();
    if ((threadIdx.x & 63) == 0) red[threadIdx.x >> 6] = v;
    __syncthreads();
    return fmaxf(fmaxf(red[0], red[1]), fmaxf(red[2], red[3]));
}

__global__ void k_rowprep(P p, int l) {
    __shared__ float red[4];
    int t = blockIdx.x, b = t / T;
    const float* xin = (l == 0 ? p.x : (const float*)(p.ws + WS_XR)) + (size_t)t * D;
    float v[8]; float s = 0;
    for (int i = 0; i < 8; ++i) { v[i] = xin[threadIdx.x + 256 * i]; s += v[i] * v[i]; }
    s = block_sum256(s, red);
    float rstd = rsqrtf(s * (1.f / D) + EPS);
    const float* mod = (const float*)(p.ws + WS_MOD) + ((size_t)l * NB + b) * 6144;
    float* h = (float*)(p.ws + WS_H) + (size_t)t * D;
    for (int i = 0; i < 8; ++i) { int d = threadIdx.x + 256 * i;
        h[d] = v[i] * rstd * p.norm_g[l * D + d] * (1.f + mod[D + d]) + mod[d]; }
}

__device__ __forceinline__ void store_proj(unsigned char* ws, int t, int c, float v) {
    if (c < 4096) { h16* base = (h16*)(ws + WS_AQ + (size_t)(c >> 10) * 16 * MiB); base[(size_t)t * 1024 + (c & 1023)] = (h16)v; return; }
    if (c < 5120) { ((h16*)(ws + WS_IQ))[(size_t)t * 1024 + (c - 4096)] = (h16)v; return; }
    if (c < 5184) { ((h16*)(ws + WS_IK))[(size_t)t * 64 + (c - 5120)] = (h16)v; return; }
    if (c < 5200) { ((float*)(ws + WS_IW))[(size_t)t * 16 + (c - 5184)] = v; return; }
    if (c < 5712) { ((h16*)(ws + WS_BQ))[(size_t)t * 512 + (c - 5200)] = (h16)(v * 0.08838834764831845f); return; }
    if (c < 6224) { ((h16*)(ws + WS_BK))[(size_t)t * 512 + (c - 5712)] = (h16)v; return; }
    if (c < 7248) { ((h16*)(ws + WS_BV))[(size_t)t * 1024 + (c - 6224)] = (h16)v; return; }
    if (c < 8272) { ((h16*)(ws + WS_BG))[(size_t)t * 1024 + (c - 7248)] = (h16)v; return; }
    ((float*)(ws + WS_BA))[(size_t)t * 16 + (c - 8272)] = v;
}
template <int MODE>
__global__ __launch_bounds__(256) void k_gemm(P p, int l) {
    __shared__ float As[16][68], Bs[16][68];
    const int N = MODE == 0 ? NCOL : D, K = D;
    const float* Bw = MODE == 0 ? p.w_in + (size_t)l * D * NCOL : p.w_out + (size_t)l * D * D;
    int tid = threadIdx.x, tx = tid & 15, ty = tid >> 4;
    int row0 = blockIdx.y * 64, col0 = blockIdx.x * 64;
    float acc[4][4] = {};
    for (int k0 = 0; k0 < K; k0 += 16) {
        { int r = tid >> 2, kq = (tid & 3) * 4; float a[4];
          if (MODE == 0) { const float* A = (const float*)(p.ws + WS_H) + (size_t)(row0 + r) * K + k0 + kq; for (int i = 0; i < 4; ++i) a[i] = A[i]; }
          else { const h16* A = (const h16*)(p.ws + WS_CAT) + (size_t)(row0 + r) * K + k0 + kq; for (int i = 0; i < 4; ++i) a[i] = (float)A[i]; }
          for (int i = 0; i < 4; ++i) As[kq + i][r] = a[i]; }
        { int kk = tid >> 4, nq = (tid & 15) * 4; int c = col0 + nq;
          for (int i = 0; i < 4; ++i) Bs[kk][nq + i] = (c + i < N) ? Bw[(size_t)(k0 + kk) * N + c + i] : 0.f; }
        __syncthreads();
#pragma unroll
        for (int kk = 0; kk < 16; ++kk) {
            float a[4], b[4];
            for (int i = 0; i < 4; ++i) a[i] = As[kk][ty * 4 + i];
            for (int j = 0; j < 4; ++j) b[j] = Bs[kk][tx * 4 + j];
            for (int i = 0; i < 4; ++i) for (int j = 0; j < 4; ++j) acc[i][j] += a[i] * b[j];
        }
        __syncthreads();
    }
    for (int i = 0; i < 4; ++i) for (int j = 0; j < 4; ++j) {
        int t = row0 + ty * 4 + i, c = col0 + tx * 4 + j;
        if (c >= N) continue;
        if (MODE == 0) store_proj(p.ws, t, c, acc[i][j]);
        else { int b = t / T; const float* mod = (const float*)(p.ws + WS_MOD) + ((size_t)l * NB + b) * 6144;
               const float* xin = (l == 0 ? p.x : (const float*)(p.ws + WS_XR));
               ((float*)(p.ws + WS_XR))[(size_t)t * D + c] = xin[(size_t)t * D + c] + mod[2 * D + c] * acc[i][j]; }
    }
}

__device__ __forceinline__ unsigned fkey(float f) { unsigned u = __float_as_uint(f); return (u & 0x80000000u) ? ~u : (u | 0x80000000u); }
__global__ __launch_bounds__(256) void k_index(P p) {
    __shared__ float iq[1024]; __shared__ float iw[16]; __shared__ unsigned key[2048]; __shared__ unsigned cnt[4]; __shared__ unsigned selw[64];
    int gt = blockIdx.x, b = gt / T, t = gt % T, tid = threadIdx.x;
    const h16* IQ = (const h16*)(p.ws + WS_IQ) + (size_t)gt * 1024;
    for (int i = tid; i < 1024; i += 256) iq[i] = (float)IQ[i];
    if (tid < 16) iw[tid] = ((const float*)(p.ws + WS_IW))[(size_t)gt * 16 + tid];
    __syncthreads();
    int n = t + 1;
    for (int s = tid; s < n; s += 256) {
        const h16* IK = (const h16*)(p.ws + WS_IK) + (size_t)(b * T + s) * 64;
        float k[64]; for (int d = 0; d < 64; ++d) k[d] = (float)IK[d];
        float sc = 0;
        for (int j = 0; j < 16; ++j) { float a = 0; for (int d = 0; d < 64; ++d) a += iq[j * 64 + d] * k[d]; sc += iw[j] * fmaxf(a, 0.f); }
        key[s] = fkey(sc);
    }
    __syncthreads();
    unsigned* MW = (unsigned*)(p.ws + WS_MASK) + (size_t)gt * 64;
    if (n <= 256) {
        if (tid < 64) { int lo = tid * 32; unsigned w = 0; if (t >= lo + 31) w = 0xffffffffu; else if (t >= lo) w = (2u << (t - lo)) - 1u; MW[tid] = w; }
        return;
    }
    unsigned Tk = 0;
    for (int bit = 31; bit >= 0; --bit) {
        unsigned cand = Tk | (1u << bit);
        if (tid < 4) cnt[tid] = 0;
        __syncthreads();
        unsigned c = 0; for (int s = tid; s < n; s += 256) c += (key[s] >= cand) ? 1u : 0u;
        for (int o = 32; o > 0; o >>= 1) c += __shfl_xor(c, o);
        if ((tid & 63) == 0) cnt[tid >> 6] = c;
        __syncthreads();
        unsigned tot = cnt[0] + cnt[1] + cnt[2] + cnt[3];
        if (tot >= 256u) Tk = cand;
        __syncthreads();
    }
    if (tid < 4) cnt[tid] = 0;
    __syncthreads();
    { unsigned c = 0; for (int s = tid; s < n; s += 256) c += (key[s] > Tk) ? 1u : 0u;
      for (int o = 32; o > 0; o >>= 1) c += __shfl_xor(c, o);
      if ((tid & 63) == 0) cnt[tid >> 6] = c; }
    __syncthreads();
    int need = 256 - (int)(cnt[0] + cnt[1] + cnt[2] + cnt[3]);
    if (tid < 64) { unsigned w = 0; for (int i = 0; i < 32; ++i) { int s = tid * 32 + i; if (s < n && key[s] > Tk) w |= 1u << i; } selw[tid] = w; }
    __syncthreads();
    if (tid == 0) { for (int s = 0; s < n && need > 0; ++s) if (key[s] == Tk) { selw[s >> 5] |= 1u << (s & 31); --need; } }
    __syncthreads();
    if (tid < 64) MW[tid] = selw[tid];
}

__device__ __forceinline__ int t5_bucket(int d) {
    if (d < 16) return d;
    float df = (float)d;
    int large = 16 + (int)(logf(df / 16.f) / logf(8.f) * 16.f);
    return large < 31 ? large : 31;
}
__global__ __launch_bounds__(256) void k_attn(P p) {
    __shared__ int sel[2048]; __shared__ int wcnt[65]; __shared__ float q[128]; __shared__ float lg[2048]; __shared__ float red[4];
    int gt = blockIdx.x, b = gt / T, t = gt % T, tid = threadIdx.x;
    const unsigned* MW = (const unsigned*)(p.ws + WS_MASK) + (size_t)gt * 64;
    if (tid < 64) wcnt[tid + 1] = __popc(MW[tid]);
    __syncthreads();
    if (tid == 0) { wcnt[0] = 0; for (int i = 0; i < 64; ++i) wcnt[i + 1] += wcnt[i]; }
    __syncthreads();
    if (tid < 64) { unsigned w = MW[tid]; int o = wcnt[tid]; while (w) { int i = __ffs(w) - 1; sel[o++] = tid * 32 + i; w &= w - 1; } }
    __syncthreads();
    int ns = wcnt[64];
    const h16* AQ = (const h16*)(p.ws + WS_AQ) + (size_t)gt * 1024;
    const h16* AK = (const h16*)(p.ws + WS_AK) + (size_t)b * T * 1024;
    const h16* AV = (const h16*)(p.ws + WS_AV) + (size_t)b * T * 1024;
    const h16* AG = (const h16*)(p.ws + WS_AG) + (size_t)gt * 1024;
    h16* CAT = (h16*)(p.ws + WS_CAT) + (size_t)gt * 2048;
    for (int h = 0; h < 8; ++h) {
        __syncthreads();
        if (tid < 128) q[tid] = (float)AQ[h * 128 + tid];
        __syncthreads();
        float mx = -1e30f;
        for (int j = tid; j < ns; j += 256) { int s = sel[j]; const h16* kr = AK + (size_t)s * 1024 + h * 128;
            float a = 0; for (int d = 0; d < 128; ++d) a += q[d] * (float)kr[d];
            a = a * 0.08838834764831845f + p.rel_bias[t5_bucket(t - s) * 8 + h];
            lg[j] = a; mx = fmaxf(mx, a); }
        mx = block_max256(mx, red);
        float sm = 0;
        for (int j = tid; j < ns; j += 256) { float e = __expf(lg[j] - mx); lg[j] = e; sm += e; }
        sm = block_sum256(sm, red);
        float inv = 1.f / sm;
        if (tid < 128) { float o = 0; for (int j = 0; j < ns; ++j) o += lg[j] * (float)AV[(size_t)sel[j] * 1024 + h * 128 + tid];
            o *= inv; CAT[h * 128 + tid] = (h16)(o * silu((float)AG[h * 128 + tid])); }
    }
}

__global__ __launch_bounds__(256) void k_gla(P p, int l) {
    __shared__ float a_s[16][128], q_s[16][128], k_s[16][128];
    int b = blockIdx.x >> 2, h = blockIdx.x & 3, tid = threadIdx.x;
    float S[128];
#pragma unroll
    for (int i = 0; i < 128; ++i) S[i] = 0.f;
    const float* BA = (const float*)(p.ws + WS_BA);
    const h16* BQ = (const h16*)(p.ws + WS_BQ); const h16* BK = (const h16*)(p.ws + WS_BK); const h16* BV = (const h16*)(p.ws + WS_BV);
    float* BO = (float*)(p.ws + WS_BO);
    const float* wup = p.w_up + (size_t)l * 16 * 512; const float* bal = p.b_alpha + l * 512;
    for (int t0 = 0; t0 < T; t0 += 16) {
        __syncthreads();
        for (int idx = tid; idx < 16 * 128; idx += 256) { int tt = idx >> 7, kk = idx & 127; size_t row = (size_t)b * T + t0 + tt;
            float pre = bal[h * 128 + kk];
            for (int r = 0; r < 16; ++r) pre += BA[row * 16 + r] * wup[r * 512 + h * 128 + kk];
            float ls = fminf(pre, 0.f) - log1pf(__expf(-fabsf(pre)));
            a_s[tt][kk] = __expf(ls * (1.f / 16.f));
            q_s[tt][kk] = (float)BQ[row * 512 + h * 128 + kk]; k_s[tt][kk] = (float)BK[row * 512 + h * 128 + kk]; }
        __syncthreads();
        for (int tt = 0; tt < 16; ++tt) { size_t row = (size_t)b * T + t0 + tt;
            float v = (float)BV[row * 1024 + h * 256 + tid]; float o = 0;
#pragma unroll
            for (int kk = 0; kk < 128; ++kk) { S[kk] = a_s[tt][kk] * S[kk] + k_s[tt][kk] * v; o += q_s[tt][kk] * S[kk]; }
            BO[row * 1024 + h * 256 + tid] = o; }
    }
}
__global__ __launch_bounds__(256) void k_gla_post(P p, int l) {
    __shared__ float red[4];
    int gt = blockIdx.x, tid = threadIdx.x;
    const float* BO = (const float*)(p.ws + WS_BO) + (size_t)gt * 1024; const h16* BG = (const h16*)(p.ws + WS_BG) + (size_t)gt * 1024;
    h16* CAT = (h16*)(p.ws + WS_CAT) + (size_t)gt * 2048 + 1024;
    for (int h = 0; h < 4; ++h) {
        float o = BO[h * 256 + tid];
        float s = block_sum256(o * o, red);
        float r = rsqrtf(s * (1.f / 256.f) + EPS);
        CAT[h * 256 + tid] = (h16)(o * r * p.gla_g[l * 256 + tid] * silu((float)BG[h * 256 + tid]));
    }
}
__global__ void k_final(P p) {
    __shared__ float red[4];
    int t = blockIdx.x;
    const float* xin = (const float*)(p.ws + WS_XR) + (size_t)t * D;
    float v[8]; float s = 0;
    for (int i = 0; i < 8; ++i) { v[i] = xin[threadIdx.x + 256 * i]; s += v[i] * v[i]; }
    s = block_sum256(s, red);
    float rstd = rsqrtf(s * (1.f / D) + EPS);
    for (int i = 0; i < 8; ++i) { int d = threadIdx.x + 256 * i; p.out[(size_t)t * D + d] = v[i] * rstd * p.final_g[d]; }
}
}

extern "C" void kernel_launch(void* const* d_in, const int* in_sizes, int n_in, void* d_out, int out_size, void* d_ws, size_t ws_size, hipStream_t stream) {
    using namespace nv;
    if (n_in != 12 || ws_size < WS_END || out_size != M * D) { fprintf(stderr, "kernel_launch: unexpected shapes n_in=%d ws=%zu out=%d\n", n_in, ws_size, out_size); return; }
    P p{};
    p.x = (const float*)d_in[0]; p.c = (const float*)d_in[1]; p.w_ada = (const float*)d_in[2]; p.b_ada = (const float*)d_in[3];
    p.norm_g = (const float*)d_in[4]; p.w_in = (const float*)d_in[5]; p.w_up = (const float*)d_in[6]; p.b_alpha = (const float*)d_in[7];
    p.gla_g = (const float*)d_in[8]; p.w_out = (const float*)d_in[9]; p.rel_bias = (const float*)d_in[10]; p.final_g = (const float*)d_in[11];
    p.out = (float*)d_out; p.ws = (unsigned char*)d_ws;
    k_cact<<<NB * D / 256, 256, 0, stream>>>(p);
    k_mod<<<NL * 6144 / 256, 256, 0, stream>>>(p);
    for (int l = 0; l < NL; ++l) {
        k_rowprep<<<M, 256, 0, stream>>>(p, l);
        k_gemm<0><<<dim3((NCOL + 63) / 64, M / 64), 256, 0, stream>>>(p, l);
        k_index<<<M, 256, 0, stream>>>(p);
        k_attn<<<M, 256, 0, stream>>>(p);
        k_gla<<<16, 256, 0, stream>>>(p, l);
        k_gla_post<<<M, 256, 0, stream>>>(p, l);
        k_gemm<1><<<dim3(D / 64, M / 64), 256, 0, stream>>>(p, l);
    }
    k_final<<<M, 256, 0, stream>>>(p);
}
```

```cpp
#include <hip/hip_runtime.h>
#include <cstdio>
#include <cstdint>

#define LAS __attribute__((address_space(3)))
#define GAS __attribute__((address_space(1)))

namespace mk {
constexpr int NB = 4, T = 2048, D = 2048, NL = 4, M = NB * T;
constexpr int NCOL = 8288;
constexpr float EPS = 1e-6f;
constexpr int NT = 512;
typedef _Float16 h16;

constexpr size_t MiB = 1u << 20;
constexpr size_t WS_CTL = 0, CTL_ZERO_BYTES = 64 * 1024;
constexpr size_t WS_MOD = 1 * MiB;
constexpr size_t WS_H = 2 * MiB;
constexpr size_t WS_XR = WS_H + 64 * MiB;
constexpr size_t WS_AQ = WS_XR + 64 * MiB;
constexpr size_t WS_AK = WS_AQ + 16 * MiB;
constexpr size_t WS_AV = WS_AK + 16 * MiB;
constexpr size_t WS_AG = WS_AV + 16 * MiB;
constexpr size_t WS_IQ = WS_AG + 16 * MiB;
constexpr size_t WS_BQ = WS_IQ + 16 * MiB;
constexpr size_t WS_BK = WS_BQ + 8 * MiB;
constexpr size_t WS_BV = WS_BK + 8 * MiB;
constexpr size_t WS_BG = WS_BV + 16 * MiB;
constexpr size_t WS_IK = WS_BG + 16 * MiB;
constexpr size_t WS_IW = WS_IK + 1 * MiB;
constexpr size_t WS_BA = WS_IW + 1 * MiB;
constexpr size_t WS_MASK = WS_BA + 1 * MiB;
constexpr size_t WS_CAT = WS_MASK + 2 * MiB;
constexpr size_t WS_BO = WS_CAT + 32 * MiB;
constexpr size_t WS_END = WS_BO + 32 * MiB;
constexpr int CW_BAR = 1024;

constexpr int LDS_BYTES = 147456;
constexpr int LDSCTL_OFF = 131072;

struct P {
    const float *x, *c, *w_ada, *b_ada, *norm_g, *w_in, *w_up, *b_alpha, *gla_g, *w_out, *rel_bias, *final_g;
    float* out; unsigned char* ws;
};

#define XB_TMO      128
#define XB_XCNT(j)  (256  + 64 * (j))
#define XB_XSUB(j)  (1280 + 64 * (j))
#define XB_XGEN(j)  (2304 + 64 * (j))
#define XB_TOP      3328
#define XB_TOPGEN   3392
#define XCD_BAR_WORDS 3456
#define XB_SPIN_CAP (1u << 18)
__device__ __forceinline__ unsigned xb_ld(unsigned* p)              { return __hip_atomic_load(p, __ATOMIC_RELAXED, __HIP_MEMORY_SCOPE_AGENT); }
__device__ __forceinline__ unsigned xb_add(unsigned* p, unsigned v) { return __hip_atomic_fetch_add(p, v, __ATOMIC_RELAXED, __HIP_MEMORY_SCOPE_AGENT); }
__device__ __forceinline__ unsigned xb_xcc_id() { return (unsigned)__builtin_amdgcn_s_getreg((3 << 11) | 20) & 0xFu; }
#define XB_SPIN(cond, bar) do { unsigned _sp = 0; while (cond) { __builtin_amdgcn_s_sleep(1); \
    if ((++_sp & 255u) == 0u) { if (xb_ld(&(bar)[XB_TMO])) break; if (_sp > XB_SPIN_CAP) { atomicAdd(&(bar)[XB_TMO], 1u); break; } } } } while (0)
struct XcdBarrier { unsigned* bar; unsigned x; volatile LAS unsigned* st; };
__device__ __forceinline__ XcdBarrier xcd_barrier_post(unsigned* bar, volatile LAS unsigned* st) {
    XcdBarrier b; b.bar = bar; b.x = xb_xcc_id(); b.st = st;
    if (threadIdx.x == 0) (void)xb_add(&bar[XB_XCNT(b.x)], 1u);
    return b;
}
__device__ __forceinline__ void xcd_barrier_complete(unsigned* bar, unsigned x, unsigned& nloc, unsigned& nx) {
    const unsigned G = gridDim.x * gridDim.y * gridDim.z;
    unsigned sum, cnt, mine, sp = 0u;
    for (;;) {
        sum = 0u; cnt = 0u; mine = 0u;
#pragma unroll
        for (unsigned j = 0; j < 16; ++j) { const unsigned c = xb_ld(&bar[XB_XCNT(j)]); sum += c; cnt += (c > 0u) ? 1u : 0u; mine = (j == x) ? c : mine; }
        if (sum == G) break;
        __builtin_amdgcn_s_sleep(1);
        if ((++sp & 255u) == 0u) { if (xb_ld(&bar[XB_TMO])) break; if (sp > XB_SPIN_CAP) { atomicAdd(&bar[XB_TMO], 1u); break; } }
    }
    nloc = mine > 0u ? mine : 1u; nx = cnt > 0u ? cnt : 1u;
}
__device__ __forceinline__ void xcd_barrier(const XcdBarrier& b) {
    asm volatile("s_waitcnt vmcnt(0)" ::: "memory");
    __syncthreads();
    if (threadIdx.x == 0) {
        unsigned* bar = b.bar;
        __builtin_amdgcn_s_waitcnt(0);
        unsigned nloc = b.st[0], nx = b.st[1];
        if (nloc == 0u) { xcd_barrier_complete(bar, b.x, nloc, nx); b.st[0] = nloc; b.st[1] = nx; }
        const unsigned old = xb_add(&bar[XB_XSUB(b.x)], 1u);
        const unsigned gen = old / nloc;
        if (old + 1u == (gen + 1u) * nloc) {
            __builtin_amdgcn_fence(__ATOMIC_RELEASE, "agent");
            asm volatile("s_waitcnt vmcnt(0)" ::: "memory");
            const unsigned og = xb_add(&bar[XB_TOP], 1u);
            const unsigned tg = og / nx;
            if (og + 1u == (tg + 1u) * nx) xb_add(&bar[XB_TOPGEN], 1u);
            else XB_SPIN(xb_ld(&bar[XB_TOPGEN]) == tg, bar);
            __builtin_amdgcn_fence(__ATOMIC_ACQUIRE, "agent");
            xb_add(&bar[XB_XGEN(b.x)], 1u);
            asm volatile("s_waitcnt vmcnt(0)" ::: "memory");
        } else {
            XB_SPIN(xb_ld(&bar[XB_XGEN(b.x)]) == gen, bar);
            __builtin_amdgcn_fence(__ATOMIC_ACQUIRE, "agent");
            asm volatile("s_waitcnt vmcnt(0)" ::: "memory");
        }
    }
    __syncthreads();
}

__device__ __forceinline__ float silu(float x) { return x / (1.f + __expf(-x)); }
__device__ __forceinline__ int tid_opaque() { int t = threadIdx.x; asm volatile("" : "+v"(t)); return t; }
__device__ __forceinline__ float wave_sum(float v) {
#pragma unroll
    for (int o = 1; o < 64; o <<= 1) v += __shfl_xor(v, o);
    return v;
}
__device__ __forceinline__ float wave_max(float v) {
#pragma unroll
    for (int o = 1; o < 64; o <<= 1) v = fmaxf(v, __shfl_xor(v, o));
    return v;
}
__device__ __forceinline__ float block_sum(float v, LAS float* red) {
    v = wave_sum(v);
    __syncthreads();
    if ((threadIdx.x & 63) == 0) red[threadIdx.x >> 6] = v;
    __syncthreads();
    float s = 0; for (int i = 0; i < NT / 64; ++i) s += red[i];
    return s;
}
__device__ __forceinline__ float block_max(float v, LAS float* red) {
    v = wave_max(v);
    __syncthreads();
    if ((threadIdx.x & 63) == 0) red[threadIdx.x >> 6] = v;
    __syncthreads();
    float s = red[0]; for (int i = 1; i < NT / 64; ++i) s = fmaxf(s, red[i]);
    return s;
}

__device__ __forceinline__ void ph_mod(const P& p, LAS unsigned char* lds, int vb0, int nvb) {
    LAS float* ca = (LAS float*)lds;
    LAS float* part = (LAS float*)(lds + 32768);
    const int tid = tid_opaque(), wave = tid >> 6, lane = tid & 63;
    for (int i = tid; i < NB * D; i += NT) ca[i] = silu(p.c[i]);
    __syncthreads();
    for (int u = vb0; u < NL * 48; u += nvb) {
        const int l = u / 48, c0 = (u % 48) * 128 + lane * 2;
        const float* w = p.w_ada + (size_t)l * D * 6144 + c0;
        float a[4][2] = {};
        const int d0 = wave * 256;
#pragma unroll 8
        for (int d = d0; d < d0 + 256; ++d) {
            const float2 wv = *(const float2*)(w + (size_t)d * 6144);
#pragma unroll
            for (int b = 0; b < 4; ++b) { const float cv = ca[b * D + d]; a[b][0] += cv * wv.x; a[b][1] += cv * wv.y; }
        }
        __syncthreads();
#pragma unroll
        for (int b = 0; b < 4; ++b) { part[(wave * 4 + b) * 128 + lane * 2] = a[b][0]; part[(wave * 4 + b) * 128 + lane * 2 + 1] = a[b][1]; }
        __syncthreads();
        { const int b = tid >> 7, col = tid & 127;
          float s = 0; for (int wv = 0; wv < 8; ++wv) s += part[(wv * 4 + b) * 128 + col];
          const int e = (u % 48) * 128 + col;
          ((float*)(p.ws + WS_MOD))[((size_t)l * NB + b) * 6144 + e] = s + p.b_ada[l * 6144 + e]; }
    }
    __syncthreads();
}

__device__ __forceinline__ void ph_rowprep(const P& p, int l, int vb0, int nvb) {
    const int tid_ = tid_opaque(), wave = tid_ >> 6, lane = tid_ & 63;
    for (int t = vb0 * 8 + wave; t < M; t += nvb * 8) {
        const int b = t / T;
        const float4* xin = (const float4*)((l == 0 ? p.x : (const float*)(p.ws + WS_XR)) + (size_t)t * D);
        float4 v[8]; float s = 0;
#pragma unroll
        for (int i = 0; i < 8; ++i) { v[i] = xin[lane + 64 * i]; s += v[i].x * v[i].x + v[i].y * v[i].y + v[i].z * v[i].z + v[i].w * v[i].w; }
        s = wave_sum(s);
        const float rstd = rsqrtf(s * (1.f / D) + EPS);
        const float* mod = (const float*)(p.ws + WS_MOD) + ((size_t)l * NB + b) * 6144;
        float4* h = (float4*)((float*)(p.ws + WS_H) + (size_t)t * D);
#pragma unroll
        for (int i = 0; i < 8; ++i) { const int d = (lane + 64 * i) * 4;
            const float4 g = *(const float4*)(p.norm_g + l * D + d), sc = *(const float4*)(mod + D + d), sh = *(const float4*)(mod + d);
            float4 o; o.x = v[i].x * rstd * g.x * (1.f + sc.x) + sh.x; o.y = v[i].y * rstd * g.y * (1.f + sc.y) + sh.y;
            o.z = v[i].z * rstd * g.z * (1.f + sc.z) + sh.z; o.w = v[i].w * rstd * g.w * (1.f + sc.w) + sh.w;
            h[lane + 64 * i] = o; }
    }
}

__device__ __forceinline__ void store_proj(unsigned char* ws, int t, int c, float v) {
    if (c < 4096) { h16* base = (h16*)(ws + WS_AQ + (size_t)(c >> 10) * 16 * MiB); base[(size_t)t * 1024 + (c & 1023)] = (h16)v; return; }
    if (c < 5120) { ((h16*)(ws + WS_IQ))[(size_t)t * 1024 + (c - 4096)] = (h16)v; return; }
    if (c < 5184) { ((h16*)(ws + WS_IK))[(size_t)t * 64 + (c - 5120)] = (h16)v; return; }
    if (c < 5200) { ((float*)(ws + WS_IW))[(size_t)t * 16 + (c - 5184)] = v; return; }
    if (c < 5712) { ((h16*)(ws + WS_BQ))[(size_t)t * 512 + (c - 5200)] = (h16)(v * 0.08838834764831845f); return; }
    if (c < 6224) { ((h16*)(ws + WS_BK))[(size_t)t * 512 + (c - 5712)] = (h16)v; return; }
    if (c < 7248) { ((h16*)(ws + WS_BV))[(size_t)t * 1024 + (c - 6224)] = (h16)v; return; }
    if (c < 8272) { ((h16*)(ws + WS_BG))[(size_t)t * 1024 + (c - 7248)] = (h16)v; return; }
    ((float*)(ws + WS_BA))[(size_t)t * 16 + (c - 8272)] = v;
}
template <int MODE>
__device__ __forceinline__ void ph_gemm_naive(const P& p, int l, LAS unsigned char* lds, int vb0, int nvb) {
    const int N = MODE == 0 ? NCOL : D, K = D;
    const int ntn = (N + 63) / 64, ntiles = ntn * (M / 64);
    const float* Bw = MODE == 0 ? p.w_in + (size_t)l * D * NCOL : p.w_out + (size_t)l * D * D;
    const int tid_ = tid_opaque(), half = tid_ >> 8, tid = tid_ & 255, tx = tid & 15, ty = tid >> 4;
    LAS float* As = (LAS float*)(lds + half * 16384);
    LAS float* Bs = As + 16 * 68;
    for (int tp = vb0; tp * 2 < ntiles; tp += nvb) {
        const int tile = tp * 2 + half; const bool live = tile < ntiles;
        const int row0 = live ? (tile / ntn) * 64 : 0, col0 = live ? (tile % ntn) * 64 : 0;
        float acc[4][4] = {};
        for (int k0 = 0; k0 < K; k0 += 16) {
            { const int r = tid >> 2, kq = (tid & 3) * 4; float a[4];
              if (MODE == 0) { const float* A = (const float*)(p.ws + WS_H) + (size_t)(row0 + r) * K + k0 + kq;
#pragma unroll
                  for (int i = 0; i < 4; ++i) a[i] = A[i]; }
              else { const h16* A = (const h16*)(p.ws + WS_CAT) + (size_t)(row0 + r) * K + k0 + kq;
#pragma unroll
                  for (int i = 0; i < 4; ++i) a[i] = (float)A[i]; }
#pragma unroll
              for (int i = 0; i < 4; ++i) As[(kq + i) * 68 + r] = a[i]; }
            { const int kk = tid >> 4, nq = (tid & 15) * 4; const int c = col0 + nq;
#pragma unroll
              for (int i = 0; i < 4; ++i) Bs[kk * 68 + nq + i] = (c + i < N) ? Bw[(size_t)(k0 + kk) * N + c + i] : 0.f; }
            __syncthreads();
#pragma unroll
            for (int kk = 0; kk < 16; ++kk) {
                float a[4], b[4];
#pragma unroll
                for (int i = 0; i < 4; ++i) a[i] = As[kk * 68 + ty * 4 + i];
#pragma unroll
                for (int j = 0; j < 4; ++j) b[j] = Bs[kk * 68 + tx * 4 + j];
#pragma unroll
                for (int i = 0; i < 4; ++i)
#pragma unroll
                    for (int j = 0; j < 4; ++j) acc[i][j] += a[i] * b[j];
            }
            __syncthreads();
        }
        if (live) {
#pragma unroll
            for (int i = 0; i < 4; ++i)
#pragma unroll
                for (int j = 0; j < 4; ++j) {
                    const int t = row0 + ty * 4 + i, c = col0 + tx * 4 + j;
                    if (c >= N) continue;
                    if (MODE == 0) store_proj(p.ws, t, c, acc[i][j]);
                    else { const int b = t / T; const float* mod = (const float*)(p.ws + WS_MOD) + ((size_t)l * NB + b) * 6144;
                           const float* xin = (l == 0 ? p.x : (const float*)(p.ws + WS_XR));
                           ((float*)(p.ws + WS_XR))[(size_t)t * D + c] = xin[(size_t)t * D + c] + mod[2 * D + c] * acc[i][j]; }
                }
        }
    }
}

__device__ __forceinline__ unsigned fkey(float f) { unsigned u = __float_as_uint(f); return (u & 0x80000000u) ? ~u : (u | 0x80000000u); }
__device__ __forceinline__ void ph_index_naive(const P& p, LAS unsigned char* lds, int vb0, int nvb) {
    LAS float* iq = (LAS float*)lds;
    LAS float* iw = iq + 1024;
    LAS unsigned* key = (LAS unsigned*)(iw + 16);
    LAS unsigned* cnt = key + 2048;
    LAS unsigned* selw = cnt + 8;
    const int tid = tid_opaque();
    for (int gt = vb0; gt < M; gt += nvb) {
        const int b = gt / T, t = gt % T;
        __syncthreads();
        const h16* IQ = (const h16*)(p.ws + WS_IQ) + (size_t)gt * 1024;
        for (int i = tid; i < 1024; i += NT) iq[i] = (float)IQ[i];
        if (tid < 16) iw[tid] = ((const float*)(p.ws + WS_IW))[(size_t)gt * 16 + tid];
        __syncthreads();
        const int n = t + 1;
        unsigned* MW = (unsigned*)(p.ws + WS_MASK) + (size_t)gt * 64;
        if (n <= 256) {
            if (tid < 64) { const int lo = tid * 32; unsigned w = 0; if (t >= lo + 31) w = 0xffffffffu; else if (t >= lo) w = (2u << (t - lo)) - 1u; MW[tid] = w; }
            continue;
        }
        for (int s = tid; s < n; s += NT) {
            const h16* IK = (const h16*)(p.ws + WS_IK) + (size_t)(b * T + s) * 64;
            float k[64];
#pragma unroll
            for (int d = 0; d < 64; ++d) k[d] = (float)IK[d];
            float sc = 0;
            for (int j = 0; j < 16; ++j) { float a = 0;
#pragma unroll
                for (int d = 0; d < 64; ++d) a += iq[j * 64 + d] * k[d];
                sc += iw[j] * fmaxf(a, 0.f); }
            key[s] = fkey(sc);
        }
        __syncthreads();
        unsigned Tk = 0;
        for (int bit = 31; bit >= 0; --bit) {
            const unsigned cand = Tk | (1u << bit);
            unsigned c = 0; for (int s = tid; s < n; s += NT) c += (key[s] >= cand) ? 1u : 0u;
            c = (unsigned)wave_sum((float)c);
            __syncthreads();
            if ((tid & 63) == 0) cnt[tid >> 6] = c;
            __syncthreads();
            unsigned tot = 0; for (int i = 0; i < 8; ++i) tot += cnt[i];
            if (tot >= 256u) Tk = cand;
        }
        { unsigned c = 0; for (int s = tid; s < n; s += NT) c += (key[s] > Tk) ? 1u : 0u;
          c = (unsigned)wave_sum((float)c);
          __syncthreads();
          if ((tid & 63) == 0) cnt[tid >> 6] = c; }
        __syncthreads();
        int need = 256; for (int i = 0; i < 8; ++i) need -= (int)cnt[i];
        if (tid < 64) { unsigned w = 0; for (int i = 0; i < 32; ++i) { const int s = tid * 32 + i; if (s < n && key[s] > Tk) w |= 1u << i; } selw[tid] = w; }
        __syncthreads();
        if (tid == 0) { for (int s = 0; s < n && need > 0; ++s) if (key[s] == Tk) { selw[s >> 5] |= 1u << (s & 31); --need; } }
        __syncthreads();
        if (tid < 64) MW[tid] = selw[tid];
    }
    __syncthreads();
}

__device__ __forceinline__ int t5_bucket(int d) {
    if (d < 16) return d;
    const float df = (float)d;
    const int large = 16 + (int)(logf(df / 16.f) / logf(8.f) * 16.f);
    return large < 31 ? large : 31;
}
__device__ __forceinline__ void ph_attn_naive(const P& p, LAS unsigned char* lds, int vb0, int nvb) {
    LAS int* sel = (LAS int*)lds;
    LAS int* wcnt = sel + 2048;
    LAS float* q = (LAS float*)(wcnt + 72);
    LAS float* lg = q + 128;
    LAS float* red = lg + 2048;
    const int tid = tid_opaque();
    for (int gt = vb0; gt < M; gt += nvb) {
        const int b = gt / T, t = gt % T;
        __syncthreads();
        const unsigned* MW = (const unsigned*)(p.ws + WS_MASK) + (size_t)gt * 64;
        if (tid < 64) wcnt[tid + 1] = __popc(MW[tid]);
        __syncthreads();
        if (tid == 0) { wcnt[0] = 0; for (int i = 0; i < 64; ++i) wcnt[i + 1] += wcnt[i]; }
        __syncthreads();
        if (tid < 64) { unsigned w = MW[tid]; int o = wcnt[tid]; while (w) { const int i = __ffs(w) - 1; sel[o++] = tid * 32 + i; w &= w - 1; } }
        __syncthreads();
        const int ns = wcnt[64];
        const h16* AQ = (const h16*)(p.ws + WS_AQ) + (size_t)gt * 1024;
        const h16* AK = (const h16*)(p.ws + WS_AK) + (size_t)b * T * 1024;
        const h16* AV = (const h16*)(p.ws + WS_AV) + (size_t)b * T * 1024;
        const h16* AG = (const h16*)(p.ws + WS_AG) + (size_t)gt * 1024;
        h16* CAT = (h16*)(p.ws + WS_CAT) + (size_t)gt * 2048;
        for (int h = 0; h < 8; ++h) {
            __syncthreads();
            if (tid < 128) q[tid] = (float)AQ[h * 128 + tid];
            __syncthreads();
            float mx = -1e30f;
            for (int j = tid; j < ns; j += NT) { const int s = sel[j]; const h16* kr = AK + (size_t)s * 1024 + h * 128;
                float a = 0; for (int d = 0; d < 128; ++d) a += q[d] * (float)kr[d];
                a = a * 0.08838834764831845f + p.rel_bias[t5_bucket(t - s) * 8 + h];
                lg[j] = a; mx = fmaxf(mx, a); }
            mx = block_max(mx, red);
            float sm = 0;
            for (int j = tid; j < ns; j += NT) { const float e = __expf(lg[j] - mx); lg[j] = e; sm += e; }
            sm = block_sum(sm, red);
            const float inv = 1.f / sm;
            if (tid < 128) { float o = 0; for (int j = 0; j < ns; ++j) o += lg[j] * (float)AV[(size_t)sel[j] * 1024 + h * 128 + tid];
                o *= inv; CAT[h * 128 + tid] = (h16)(o * silu((float)AG[h * 128 + tid])); }
        }
    }
    __syncthreads();
}

__device__ __forceinline__ void ph_gla_naive(const P& p, int l, LAS unsigned char* lds, int vb0, int nvb) {
    const int tid = tid_opaque(), col = tid >> 1, kh = tid & 1;
    LAS float* a_s = (LAS float*)lds;
    LAS float* q_s = a_s + 2048;
    LAS float* k_s = q_s + 2048;
    const float* BA = (const float*)(p.ws + WS_BA);
    const h16* BQ = (const h16*)(p.ws + WS_BQ); const h16* BK = (const h16*)(p.ws + WS_BK); const h16* BV = (const h16*)(p.ws + WS_BV);
    float* BO = (float*)(p.ws + WS_BO);
    const float* wup = p.w_up + (size_t)l * 16 * 512; const float* bal = p.b_alpha + l * 512;
    for (int bh = vb0; bh < 16; bh += nvb) {
        const int b = bh >> 2, h = bh & 3;
        float S[64];
#pragma unroll
        for (int i = 0; i < 64; ++i) S[i] = 0.f;
        for (int t0 = 0; t0 < T; t0 += 16) {
            __syncthreads();
            for (int idx = tid; idx < 16 * 128; idx += NT) { const int tt = idx >> 7, kk = idx & 127; const size_t row = (size_t)b * T + t0 + tt;
                float pre = bal[h * 128 + kk];
                for (int r = 0; r < 16; ++r) pre += BA[row * 16 + r] * wup[r * 512 + h * 128 + kk];
                const float ls = fminf(pre, 0.f) - log1pf(__expf(-fabsf(pre)));
                a_s[idx] = __expf(ls * (1.f / 16.f));
                q_s[idx] = (float)BQ[row * 512 + h * 128 + kk]; k_s[idx] = (float)BK[row * 512 + h * 128 + kk]; }
            __syncthreads();
            for (int tt = 0; tt < 16; ++tt) { const size_t row = (size_t)b * T + t0 + tt;
                const float v = (float)BV[row * 1024 + h * 256 + col]; float o = 0;
                const int kb = tt * 128 + kh * 64;
#pragma unroll
                for (int kk = 0; kk < 64; ++kk) { S[kk] = a_s[kb + kk] * S[kk] + k_s[kb + kk] * v; o += q_s[kb + kk] * S[kk]; }
                o += __shfl_xor(o, 1);
                if (kh == 0) BO[row * 1024 + h * 256 + col] = o; }
        }
    }
    __syncthreads();
}
__device__ __forceinline__ void ph_gla_post(const P& p, int l, int vb0, int nvb) {
    const int tid_ = tid_opaque(), wave = tid_ >> 6, lane = tid_ & 63;
    for (int it = vb0 * 8 + wave; it < M * 4; it += nvb * 8) {
        const int gt = it >> 2, h = it & 3;
        const float4 o = *(const float4*)((const float*)(p.ws + WS_BO) + (size_t)gt * 1024 + h * 256 + lane * 4);
        const float s = wave_sum(o.x * o.x + o.y * o.y + o.z * o.z + o.w * o.w);
        const float r = rsqrtf(s * (1.f / 256.f) + EPS);
        const h16* BG = (const h16*)(p.ws + WS_BG) + (size_t)gt * 1024 + h * 256 + lane * 4;
        const float* g = p.gla_g + l * 256 + lane * 4;
        h16* CAT = (h16*)(p.ws + WS_CAT) + (size_t)gt * 2048 + 1024 + h * 256 + lane * 4;
        CAT[0] = (h16)(o.x * r * g[0] * silu((float)BG[0])); CAT[1] = (h16)(o.y * r * g[1] * silu((float)BG[1]));
        CAT[2] = (h16)(o.z * r * g[2] * silu((float)BG[2])); CAT[3] = (h16)(o.w * r * g[3] * silu((float)BG[3]));
    }
}
__device__ __forceinline__ void ph_final(const P& p, int vb0, int nvb) {
    const int tid_ = tid_opaque(), wave = tid_ >> 6, lane = tid_ & 63;
    for (int t = vb0 * 8 + wave; t < M; t += nvb * 8) {
        const float4* xin = (const float4*)((const float*)(p.ws + WS_XR) + (size_t)t * D);
        float4 v[8]; float s = 0;
#pragma unroll
        for (int i = 0; i < 8; ++i) { v[i] = xin[lane + 64 * i]; s += v[i].x * v[i].x + v[i].y * v[i].y + v[i].z * v[i].z + v[i].w * v[i].w; }
        s = wave_sum(s);
        const float rstd = rsqrtf(s * (1.f / D) + EPS);
        float4* o = (float4*)(p.out + (size_t)t * D);
#pragma unroll
        for (int i = 0; i < 8; ++i) { const float4 g = *(const float4*)(p.final_g + (lane + 64 * i) * 4);
            float4 r; r.x = v[i].x * rstd * g.x; r.y = v[i].y * rstd * g.y; r.z = v[i].z * rstd * g.z; r.w = v[i].w * rstd * g.w; o[lane + 64 * i] = r; }
    }
}

__global__ void __launch_bounds__(NT, 2) mega_fwd(P p) {
    extern __shared__ __attribute__((aligned(16))) unsigned char lds_raw[];
    LAS unsigned char* lds = (LAS unsigned char*)lds_raw;
    const int tid = threadIdx.x;
    for (int u = tid; u < (LDS_BYTES - LDSCTL_OFF) / 4; u += NT) ((LAS unsigned*)(lds + LDSCTL_OFF))[u] = 0u;
    __syncthreads();
    XcdBarrier bar = xcd_barrier_post((unsigned*)(p.ws + WS_CTL) + CW_BAR, (volatile LAS unsigned*)(lds + LDSCTL_OFF + 64));
    const int G = gridDim.x, vb = blockIdx.x;

    ph_mod(p, lds, vb, G);
    xcd_barrier(bar);
    for (int l = 0; l < NL; ++l) {
        ph_rowprep(p, l, vb, G);
        xcd_barrier(bar);
        ph_gemm_naive<0>(p, l, lds, vb, G);
        xcd_barrier(bar);
        ph_index_naive(p, lds, vb, G);
        xcd_barrier(bar);
        ph_attn_naive(p, lds, vb, G);
        ph_gla_naive(p, l, lds, vb, G);
        xcd_barrier(bar);
        ph_gla_post(p, l, vb, G);
        xcd_barrier(bar);
        ph_gemm_naive<1>(p, l, lds, vb, G);
        xcd_barrier(bar);
    }
    ph_final(p, vb, G);
}
}

extern "C" void kernel_launch(void* const* d_in, const int* in_sizes, int n_in, void* d_out, int out_size, void* d_ws, size_t ws_size, hipStream_t stream) {
    using namespace mk;
    static int grid = 0;
    if (grid == 0) {
        if (n_in != 12 || ws_size < WS_END || out_size != M * D) { fprintf(stderr, "kernel_launch: unexpected shapes n_in=%d ws=%zu out=%d\n", n_in, ws_size, out_size); grid = -1; return; }
        int dev = 0, cus = 0;
        if (hipGetDevice(&dev) != hipSuccess || hipDeviceGetAttribute(&cus, hipDeviceAttributeMultiprocessorCount, dev) != hipSuccess) { grid = -1; return; }
        if (hipFuncSetAttribute((const void*)mega_fwd, hipFuncAttributeMaxDynamicSharedMemorySize, LDS_BYTES) != hipSuccess) { fprintf(stderr, "kernel_launch: hipFuncSetAttribute failed\n"); grid = -1; return; }
        int per_cu = 0;
        if (hipOccupancyMaxActiveBlocksPerMultiprocessor(&per_cu, (const void*)mega_fwd, NT, LDS_BYTES) != hipSuccess || per_cu < 1)
            fprintf(stderr, "kernel_launch: note: occupancy query reports %d workgroups per CU\n", per_cu);
        (void)hipGetLastError();
        grid = cus;
    }
    if (grid < 0) return;
    if (hipMemsetAsync((char*)d_ws + WS_CTL, 0, CTL_ZERO_BYTES, stream) != hipSuccess) { fprintf(stderr, "kernel_launch: memset failed\n"); return; }
    P p{};
    p.x = (const float*)d_in[0]; p.c = (const float*)d_in[1]; p.w_ada = (const float*)d_in[2]; p.b_ada = (const float*)d_in[3];
    p.norm_g = (const float*)d_in[4]; p.w_in = (const float*)d_in[5]; p.w_up = (const float*)d_in[6]; p.b_alpha = (const float*)d_in[7];
    p.gla_g = (const float*)d_in[8]; p.w_out = (const float*)d_in[9]; p.rel_bias = (const float*)d_in[10]; p.final_g = (const float*)d_in[11];
    p.out = (float*)d_out; p.ws = (unsigned char*)d_ws;
    hipLaunchKernelGGL(mega_fwd, dim3(grid), dim3(NT), LDS_BYTES, stream, p);
}
```
